# Optimizing an MI355X kernel written in HIP

```python
import jax, jax.numpy as jnp
from jax import lax
import numpy as np

D_MODEL = 1024
BATCH = 32
SEQ = 2048
DEPTH = 1

CHUNK = 64
HEAD_DIM = 64
MIX_WIDTH = D_MODEL
A_WIDTH = MIX_WIDTH // 2
B_WIDTH = MIX_WIDTH - A_WIDTH
A_HEADS = A_WIDTH // HEAD_DIM
A_KV_HEADS = max(1, A_HEADS // 4)
B_HEADS = B_WIDTH // HEAD_DIM
WINDOW = 128
A_PREV_CHUNKS = WINDOW // CHUNK
B_PREV_CHUNKS = 8
MAX_REL = 128
PLE_DIM = 256
RMS_EPS = 1e-6
NEG_BIG = -1e30

A_Q = A_HEADS * HEAD_DIM
A_KV = A_KV_HEADS * HEAD_DIM
PROJ_SIZES = (A_Q, A_KV, A_KV, A_WIDTH, B_WIDTH, B_WIDTH, B_WIDTH, B_WIDTH)
D_IN_PROJ = sum(PROJ_SIZES)
SPLIT_POINTS = [int(v) for v in np.cumsum(PROJ_SIZES)[:-1]]

kernel_name = "hybrid_chunk_swa_sink_relbias_ple"


def rmsnorm(x, g):
    xf = x.astype(jnp.float32)
    var = jnp.mean(xf * xf, axis=-1, keepdims=True)
    return (xf * lax.rsqrt(var + RMS_EPS)).astype(x.dtype) * g


def band_rel(n_prev):
    band = (n_prev + 1) * CHUNK
    qi = jnp.arange(CHUNK, dtype=jnp.int32)[:, None]
    kj = jnp.arange(band, dtype=jnp.int32)[None, :]
    return qi - kj + n_prev * CHUNK


def alibi_bias(n_heads, n_prev):
    slopes = jnp.asarray(2.0 ** (-8.0 * np.arange(1, n_heads + 1) / n_heads), dtype=jnp.float32)
    dist = jnp.abs(band_rel(n_prev)).astype(jnp.float32)
    return -slopes[:, None, None] * dist[None]


def rel_position_bias(table, n_prev):
    idx = jnp.clip(band_rel(n_prev), -MAX_REL, MAX_REL) + MAX_REL
    return table.astype(jnp.float32)[:, idx]


def chunk_band_attention(q, k, v, n_prev, bias, sink):
    b, s, hq, d = q.shape
    hkv = k.shape[2]
    grp = hq // hkv
    nc = s // CHUNK
    band = (n_prev + 1) * CHUNK
    pad = n_prev * CHUNK
    kp = jnp.pad(k, ((0, 0), (pad, 0), (0, 0), (0, 0)))
    vp = jnp.pad(v, ((0, 0), (pad, 0), (0, 0), (0, 0)))
    qc = q.reshape(b, nc, CHUNK, hkv, grp, d)
    bias_g = bias.reshape(hkv, grp, CHUNK, band)
    scale = HEAD_DIM ** -0.5
    if sink is not None:
        sink_g = sink.astype(jnp.float32).reshape(hkv, grp, 1, 1)

    def one_chunk(c):
        qb = lax.dynamic_index_in_dim(qc, c, axis=1, keepdims=False)
        kb = lax.dynamic_slice_in_dim(kp, c * CHUNK, band, axis=1)
        vb = lax.dynamic_slice_in_dim(vp, c * CHUNK, band, axis=1)
        sc = jnp.einsum('bqkgd,bskd->bkgqs', qb, kb).astype(jnp.float32) * scale + bias_g
        valid = jnp.arange(band) >= pad - c * CHUNK
        sc = jnp.where(valid, sc, NEG_BIG)
        m = jnp.max(sc, axis=-1, keepdims=True)
        if sink is not None:
            m = jnp.maximum(m, sink_g)
            e = jnp.exp(sc - m)
            denom = jnp.sum(e, axis=-1, keepdims=True) + jnp.exp(sink_g - m)
        else:
            e = jnp.exp(sc - m)
            denom = jnp.sum(e, axis=-1, keepdims=True)
        w = (e / denom).astype(vb.dtype)
        out = jnp.einsum('bkgqs,bskd->bqkgd', w, vb)
        return out.reshape(b, CHUNK, hq * d)

    out = lax.map(one_chunk, jnp.arange(nc))
    return jnp.transpose(out, (1, 0, 2, 3)).reshape(b, s, hq * d)


def setup_inputs(seed: int = 0) -> dict:
    key = jax.random.key(seed)
    ks = jax.random.split(key, 12)
    f32 = jnp.float32
    x = jax.random.normal(ks[0], (BATCH, SEQ, D_MODEL), f32)
    p = jax.random.normal(ks[1], (DEPTH, BATCH, SEQ, PLE_DIM), f32)
    norm_g = 1.0 + 0.02 * jax.random.normal(ks[2], (DEPTH, D_MODEL), f32)
    w_in = jax.random.normal(ks[3], (DEPTH, D_MODEL, D_IN_PROJ), f32) * D_MODEL ** -0.5
    sink_a = 0.5 * jax.random.normal(ks[4], (DEPTH, A_HEADS), f32)
    rel_bias_b = 0.1 * jax.random.normal(ks[5], (DEPTH, B_HEADS, 2 * MAX_REL + 1), f32)
    w_out = jax.random.normal(ks[6], (DEPTH, MIX_WIDTH, D_MODEL), f32) * MIX_WIDTH ** -0.5
    ple_norm_g = 1.0 + 0.02 * jax.random.normal(ks[7], (DEPTH, D_MODEL), f32)
    w_ple_proj = jax.random.normal(ks[8], (DEPTH, PLE_DIM, D_MODEL), f32) * PLE_DIM ** -0.5
    w_ple_gate = jax.random.normal(ks[9], (DEPTH, D_MODEL, D_MODEL), f32) * D_MODEL ** -0.5
    final_norm_g = 1.0 + 0.02 * jax.random.normal(ks[10], (D_MODEL,), f32)
    return {"x": x, "p": p, "norm_g": norm_g, "w_in": w_in, "sink_a": sink_a,
            "rel_bias_b": rel_bias_b, "w_out": w_out, "ple_norm_g": ple_norm_g,
            "w_ple_proj": w_ple_proj, "w_ple_gate": w_ple_gate, "final_norm_g": final_norm_g}


def reference(x, p, norm_g, w_in, sink_a, rel_bias_b, w_out, ple_norm_g, w_ple_proj, w_ple_gate, final_norm_g):
    b, s, _ = x.shape
    bias_a = alibi_bias(A_HEADS, A_PREV_CHUNKS)
    h = x
    for i in range(DEPTH):
        u = rmsnorm(h, norm_g[i])
        z = u @ w_in[i]
        qa, ka, va, ga, qb, kb, vb, gb = jnp.split(z, SPLIT_POINTS, axis=-1)
        ya = chunk_band_attention(
            qa.reshape(b, s, A_HEADS, HEAD_DIM),
            ka.reshape(b, s, A_KV_HEADS, HEAD_DIM),
            va.reshape(b, s, A_KV_HEADS, HEAD_DIM),
            A_PREV_CHUNKS, bias_a, sink_a[i])
        bias_b = rel_position_bias(rel_bias_b[i], B_PREV_CHUNKS)
        yb = chunk_band_attention(
            qb.reshape(b, s, B_HEADS, HEAD_DIM),
            kb.reshape(b, s, B_HEADS, HEAD_DIM),
            vb.reshape(b, s, B_HEADS, HEAD_DIM),
            B_PREV_CHUNKS, bias_b, None)
        y = jnp.concatenate([ya * jax.nn.silu(ga), yb * jax.nn.silu(gb)], axis=-1)
        h = h + y @ w_out[i]
        gate = jax.nn.sigmoid(rmsnorm(h, ple_norm_g[i]) @ w_ple_gate[i])
        h = h + (p[i] @ w_ple_proj[i]) * gate
    return rmsnorm(h, final_norm_g)
```

```cpp
#include <hip/hip_runtime.h>
#include <hip/hip_cooperative_groups.h>
#include <cstdio>
#include <cstdint>
namespace cg = cooperative_groups;
namespace pg8 {
#define PG8_LAS __attribute__((address_space(3)))
typedef unsigned short bf16_t;
typedef short bf16x8 __attribute__((ext_vector_type(8)));
typedef float f32x4 __attribute__((ext_vector_type(4)));
typedef unsigned u32x4 __attribute__((ext_vector_type(4)));
constexpr int BM = 256, BK = 64, HALF = 128, HTB = HALF * BK * 2  , STAGE_BYTES = 8 * HTB, NXCD = 8, WGM = 8;

__host__ __device__ __forceinline__ int lds_byte(int r, int c) { const int st = (r >> 4) * 2 + (c >> 5), rr = r & 15, cc = c & 31, ob = rr * 64 + cc * 2; return st * 1024 + (ob ^ (((ob >> 9) & 1) << 5)); }
__host__ __device__ __forceinline__ void stage_rc(int b, int& R, int& C) { const int st = b / 1024, sb = b % 1024, swz = sb ^ (((sb >> 9) & 1) << 5); R = (st >> 1) * 16 + swz / 64; C = (st & 1) * 32 + (swz % 64) / 2; }
__host__ __device__ __forceinline__ int perm32(int rho) { const int n = rho >> 4, i = rho & 15; return 8 * (i >> 2) + 4 * n + (i & 3); }

struct Unit { int pm, pn; };
struct Gemm { const bf16_t* A; const bf16_t* Bt; int M, N, K; };

struct StaticOrder {
    int nM, nN, nwg, G, c;
    __host__ __device__ void init(int M, int N, int G_, int c_) { nM = M / BM; nN = N / BM; nwg = nM * nN; G = G_; c = c_; }
    __host__ __device__ bool next(int i, Unit& u) const {
        const long L = (long)i * G + c; if (L >= nwg) return false;
        int wgid = (int)L; { const int q = nwg / NXCD, r = nwg % NXCD, xcd = wgid % NXCD, off = wgid / NXCD; wgid = (xcd < r ? xcd * (q + 1) : r * (q + 1) + (xcd - r) * q) + off; }
        const int nig = WGM * nN, gid = wgid / nig, fm = gid * WGM, gsz = (nM - fm) < WGM ? (nM - fm) : WGM;
        u.pm = fm + ((wgid % nig) % gsz); u.pn = (wgid % nig) / gsz; return true;
    }
    __device__ __forceinline__ void a_ready(const Unit&) const {}
    __device__ __forceinline__ void done(const Unit&) const {}
};
__device__ __forceinline__ unsigned cvt_pk_bf16(float lo, float hi) { unsigned r; asm volatile("v_cvt_pk_bf16_f32 %0, %1, %2" : "=v"(r) : "v"(lo), "v"(hi)); return r; }
typedef float f32x2 __attribute__((ext_vector_type(2)));
typedef unsigned u32x2 __attribute__((ext_vector_type(2)));
struct EpiBf16S {
    static constexpr bool PERM = true, AFTER_DRAIN = false;
    bf16_t* O; int ldc; float qscale; unsigned qmask;
    __device__ __forceinline__ void operator()(const f32x4 (&acc)[2][2][4][2], const Unit& u, int wr, int wc, int fr, int fq) const {
        const int row0 = u.pm * BM + wr * 64 + fr, col0 = u.pn * BM + wc * 32 + 8 * fq;
        const float sc = ((qmask >> u.pn) & 1u) ? qscale : 1.f;
#pragma unroll
        for (int ai = 0; ai < 2; ++ai)
#pragma unroll
            for (int m = 0; m < 4; ++m) { bf16_t* rowp = O + (size_t)(row0 + ai * HALF + m * 16) * ldc + col0;
#pragma unroll
                for (int bj = 0; bj < 2; ++bj) { const f32x4 v0 = acc[ai][bj][m][0] * sc, v1 = acc[ai][bj][m][1] * sc;
                    u32x4 w; w.x = cvt_pk_bf16(v0[0], v0[1]); w.y = cvt_pk_bf16(v0[2], v0[3]); w.z = cvt_pk_bf16(v1[0], v1[1]); w.w = cvt_pk_bf16(v1[2], v1[3]);
                    *(u32x4*)(rowp + bj * HALF) = w; } }
    }
};
struct EpiRes {
    static constexpr bool PERM = true, AFTER_DRAIN = false;
    const float* X; float* H; bf16_t* HB; float* part;
    __device__ __forceinline__ void operator()(const f32x4 (&acc)[2][2][4][2], const Unit& u, int wr, int wc, int fr, int fq) const {
        const int row0 = u.pm * BM + wr * 64 + fr, col0 = u.pn * BM + wc * 32 + 8 * fq;
#pragma unroll
        for (int ai = 0; ai < 2; ++ai)
#pragma unroll
            for (int m = 0; m < 4; ++m) { const size_t row = (size_t)(row0 + ai * HALF + m * 16); const size_t off = row * 1024 + col0; float ss = 0.f;
#pragma unroll
                for (int bj = 0; bj < 2; ++bj) { const f32x4 xa = *(const f32x4*)(X + off + bj * HALF), xb = *(const f32x4*)(X + off + bj * HALF + 4);
                    const f32x4 v0 = acc[ai][bj][m][0] + xa, v1 = acc[ai][bj][m][1] + xb;
                    *(f32x4*)(H + off + bj * HALF) = v0; *(f32x4*)(H + off + bj * HALF + 4) = v1;
                    ss += (v0[0] * v0[0] + v0[1] * v0[1]) + (v0[2] * v0[2] + v0[3] * v0[3]) + (v1[0] * v1[0] + v1[1] * v1[1]) + (v1[2] * v1[2] + v1[3] * v1[3]);
                    u32x4 w; w.x = cvt_pk_bf16(v0[0], v0[1]); w.y = cvt_pk_bf16(v0[2], v0[3]); w.z = cvt_pk_bf16(v1[0], v1[1]); w.w = cvt_pk_bf16(v1[2], v1[3]);
                    *(u32x4*)(HB + off + bj * HALF) = w; }
                ss += __shfl_xor(ss, 16); ss += __shfl_xor(ss, 32);
                if (fq == 0) part[row * 16 + u.pn * 4 + wc] = ss; }
    }
};
__device__ __forceinline__ float sigmoidf_fast(float t) { return __builtin_amdgcn_rcpf(1.0f + __builtin_amdgcn_exp2f(-1.4426950408889634f * t)); }
struct EpiFin {
    static constexpr bool PERM = true, AFTER_DRAIN = false;
    float* H; const bf16_t* PP; const float* part; float eps;
    __device__ __forceinline__ void operator()(const f32x4 (&acc)[2][2][4][2], const Unit& u, int wr, int wc, int fr, int fq) const {
        const int row0 = u.pm * BM + wr * 64 + fr, col0 = u.pn * BM + wc * 32 + 8 * fq;
#pragma unroll
        for (int ai = 0; ai < 2; ++ai)
#pragma unroll
            for (int m = 0; m < 4; ++m) { const size_t row = (size_t)(row0 + ai * HALF + m * 16); const size_t off = row * 1024 + col0;
                const f32x4* pr = (const f32x4*)(part + row * 16); const f32x4 pa = pr[0], pb = pr[1], pc = pr[2], pd = pr[3];
                const float ss = ((pa[0] + pa[1]) + (pa[2] + pa[3])) + ((pb[0] + pb[1]) + (pb[2] + pb[3])) + ((pc[0] + pc[1]) + (pc[2] + pc[3])) + ((pd[0] + pd[1]) + (pd[2] + pd[3]));
                const float rstd = 1.0f / sqrtf(ss * (1.0f / 1024.0f) + eps);
#pragma unroll
                for (int bj = 0; bj < 2; ++bj) { float* hp = H + off + bj * HALF; f32x4 h0 = *(const f32x4*)hp, h1 = *(const f32x4*)(hp + 4);
                    const u32x4 pw = *(const u32x4*)(PP + off + bj * HALF);
                    const f32x4 a0 = acc[ai][bj][m][0] * rstd, a1 = acc[ai][bj][m][1] * rstd;
                    h0[0] += __uint_as_float(pw.x << 16) * sigmoidf_fast(a0[0]); h0[1] += __uint_as_float(pw.x & 0xffff0000u) * sigmoidf_fast(a0[1]);
                    h0[2] += __uint_as_float(pw.y << 16) * sigmoidf_fast(a0[2]); h0[3] += __uint_as_float(pw.y & 0xffff0000u) * sigmoidf_fast(a0[3]);
                    h1[0] += __uint_as_float(pw.z << 16) * sigmoidf_fast(a1[0]); h1[1] += __uint_as_float(pw.z & 0xffff0000u) * sigmoidf_fast(a1[1]);
                    h1[2] += __uint_as_float(pw.w << 16) * sigmoidf_fast(a1[2]); h1[3] += __uint_as_float(pw.w & 0xffff0000u) * sigmoidf_fast(a1[3]);
                    *(f32x4*)hp = h0; *(f32x4*)(hp + 4) = h1; } }
    }
};
template <class Epi, class Sched, bool ALIGN_EPI = false, bool SP2 = false>
__device__ __forceinline__ void gemm_phase(PG8_LAS unsigned char* lds, const Gemm g, const Sched& S, const Epi& E) {
    const int tid = threadIdx.x, wid = __builtin_amdgcn_readfirstlane(tid >> 6), lane = tid & 63, wr = wid >> 2, wc = wid & 3, fr = lane & 15, fq = lane >> 4;
    const int K = g.K, nt = K / BK;
    unsigned voffA[2], voffB[2];
#pragma unroll
    for (int i = 0; i < 2; ++i) { int R, C; stage_rc(tid * 16 + i * 8192, R, C); const int Rb = Epi::PERM ? ((R & ~31) + perm32(R & 31)) : R;
        voffA[i] = (unsigned)(R * K + C) * 2u; voffB[i] = (unsigned)(Rb * K + C) * 2u; }
    const size_t kstep = (size_t)(BK * 2);
    const size_t hstep = (size_t)HALF * K * 2;
    const size_t tstep = 2 * hstep;
    const unsigned ldsw = (unsigned)wid * 1024u;
    const int aoff = lds_byte(wr * 64 + fr, fq * 8), boff = lds_byte(wc * 32 + fr, fq * 8);
#define PG8_SA(b, h) (((b) * 2 + (h)) * HTB)
#define PG8_SB(b, h) ((4 + (b) * 2 + (h)) * HTB)
#define PG8_STAGE(bufoff, gbase, voff) do { _Pragma("unroll") for (int _i = 0; _i < 2; ++_i) \
        __builtin_amdgcn_global_load_lds((const unsigned*)((const char*)(gbase) + (voff)[_i]), (PG8_LAS unsigned*)(lds + (bufoff) + ldsw + _i * 8192), 16, 0, 0); } while (0)
#define PG8_LDA(dst, b, h) do { _Pragma("unroll") for (int m = 0; m < 4; ++m) _Pragma("unroll") for (int k = 0; k < 2; ++k) dst[m][k] = *(const PG8_LAS bf16x8*)(lds + PG8_SA(b, h) + aoff + m * 2048 + k * 1024); } while (0)
#define PG8_LDB(dst, b, h) do { _Pragma("unroll") for (int n = 0; n < 2; ++n) _Pragma("unroll") for (int k = 0; k < 2; ++k) dst[n][k] = *(const PG8_LAS bf16x8*)(lds + PG8_SB(b, h) + boff + n * 2048 + k * 1024); } while (0)
#define PG8_MMA(ai, bj, At, Bt) do { __builtin_amdgcn_s_setprio(1); _Pragma("unroll") for (int m = 0; m < 4; ++m) _Pragma("unroll") for (int n = 0; n < 2; ++n) _Pragma("unroll") for (int k = 0; k < 2; ++k) \
        acc[ai][bj][m][n] = __builtin_amdgcn_mfma_f32_16x16x32_bf16(Bt[n][k], At[m][k], acc[ai][bj][m][n], 0, 0, 0); __builtin_amdgcn_s_setprio(0); } while (0)
#define PG8_WAIT_V(n) asm volatile("s_waitcnt vmcnt(" #n ")" ::: "memory")
#define PG8_WAIT_L(n) asm volatile("s_waitcnt lgkmcnt(" #n ")" ::: "memory")
#define PG8_BAR __builtin_amdgcn_s_barrier()
#define PG8_SCHED __builtin_amdgcn_sched_barrier(0)
    Unit cur, nxt; int ui = 0;
    if (!S.next(0, cur)) return;
    f32x4 acc[2][2][4][2];
#pragma unroll
    for (int a = 0; a < 2; ++a)
#pragma unroll
        for (int b = 0; b < 2; ++b)
#pragma unroll
            for (int m = 0; m < 4; ++m)
#pragma unroll
                for (int n = 0; n < 2; ++n) acc[a][b][m][n] = (f32x4){0.f, 0.f, 0.f, 0.f};
    bf16x8 At[4][2], B0[2][2], B1[2][2];
    const char* cA = (const char*)g.A + (size_t)cur.pm * tstep; const char* cB = (const char*)g.Bt + (size_t)cur.pn * tstep;
    S.a_ready(cur);
    if constexpr (SP2) {
        PG8_STAGE(PG8_SB(0, 0), cB, voffB); PG8_STAGE(PG8_SB(0, 1), cB + hstep, voffB); PG8_STAGE(PG8_SA(0, 0), cA, voffA); PG8_STAGE(PG8_SA(0, 1), cA + hstep, voffA);
        if (wr == 1) PG8_BAR;
        PG8_WAIT_V(2); PG8_BAR;
        PG8_STAGE(PG8_SB(1, 0), cB + kstep, voffB); PG8_STAGE(PG8_SA(1, 0), cA + kstep, voffA); PG8_STAGE(PG8_SB(1, 1), cB + hstep + kstep, voffB);
        PG8_WAIT_V(6); PG8_BAR;
    } else {
        PG8_STAGE(PG8_SB(0, 0), cB, voffB); PG8_STAGE(PG8_SA(0, 0), cA, voffA); PG8_STAGE(PG8_SB(0, 1), cB + hstep, voffB); PG8_STAGE(PG8_SA(0, 1), cA + hstep, voffA);
        if (wr == 1) PG8_BAR;
        PG8_WAIT_V(4); PG8_BAR;
        PG8_STAGE(PG8_SB(1, 0), cB + kstep, voffB); PG8_STAGE(PG8_SA(1, 0), cA + kstep, voffA); PG8_STAGE(PG8_SB(1, 1), cB + hstep + kstep, voffB);
        PG8_WAIT_V(6); PG8_BAR;
    }
    for (;;) {
        const bool has_next = S.next(ui + 1, nxt);
        const char* nA = has_next ? (const char*)g.A + (size_t)nxt.pm * tstep : cA; const char* nB = has_next ? (const char*)g.Bt + (size_t)nxt.pn * tstep : cB;
        for (int t = 0; t < nt; t += 2) {
            const bool last = (t == nt - 2);
            const char* a1 = cA + (size_t)(t + 1) * kstep;
            const char* a2 = last ? nA : cA + (size_t)(t + 2) * kstep; const char* b2 = last ? nB : cB + (size_t)(t + 2) * kstep;
            const char* a3 = a2 + kstep; const char* b3 = b2 + kstep;
            if (last && has_next) S.a_ready(nxt);
            if constexpr (SP2) {
            PG8_LDB(B0, 0, 0); PG8_LDB(B1, 0, 1); PG8_SCHED; PG8_LDA(At, 0, 0); PG8_STAGE(PG8_SA(1, 1), a1 + hstep, voffA);
            PG8_WAIT_V(8); PG8_WAIT_L(0); PG8_BAR; PG8_MMA(0, 0, At, B0); PG8_MMA(0, 1, At, B1); PG8_BAR; PG8_SCHED;
            PG8_LDA(At, 0, 1); PG8_STAGE(PG8_SB(0, 0), b2, voffB); PG8_STAGE(PG8_SB(0, 1), b2 + hstep, voffB); PG8_STAGE(PG8_SA(0, 0), a2, voffA);
            PG8_WAIT_V(8); PG8_WAIT_L(0); PG8_BAR; PG8_MMA(1, 0, At, B0); PG8_MMA(1, 1, At, B1); PG8_BAR; PG8_SCHED;
            PG8_LDB(B0, 1, 0); PG8_LDB(B1, 1, 1); PG8_SCHED; PG8_LDA(At, 1, 0); PG8_STAGE(PG8_SA(0, 1), a2 + hstep, voffA);
            PG8_WAIT_V(8); PG8_WAIT_L(0); PG8_BAR; PG8_MMA(0, 0, At, B0); PG8_MMA(0, 1, At, B1); PG8_BAR; PG8_SCHED;
            PG8_LDA(At, 1, 1); PG8_STAGE(PG8_SB(1, 0), b3, voffB); PG8_STAGE(PG8_SB(1, 1), b3 + hstep, voffB); PG8_STAGE(PG8_SA(1, 0), a3, voffA);
            PG8_WAIT_V(8); PG8_WAIT_L(0); PG8_BAR; PG8_MMA(1, 0, At, B0); PG8_MMA(1, 1, At, B1); PG8_BAR; PG8_SCHED;
            } else {
            PG8_LDB(B0, 0, 0); PG8_SCHED; PG8_LDA(At, 0, 0); PG8_STAGE(PG8_SA(1, 1), a1 + hstep, voffA);
            PG8_WAIT_L(8); PG8_BAR; PG8_WAIT_L(0); PG8_MMA(0, 0, At, B0); PG8_BAR; PG8_SCHED;
            PG8_LDB(B1, 0, 1); PG8_STAGE(PG8_SB(0, 0), b2, voffB);
            PG8_BAR; PG8_WAIT_L(0); PG8_MMA(0, 1, At, B1); PG8_BAR;
            PG8_LDA(At, 0, 1); PG8_STAGE(PG8_SA(0, 0), a2, voffA);
            PG8_BAR; PG8_WAIT_L(0); PG8_MMA(1, 0, At, B0); PG8_BAR; PG8_SCHED;
            PG8_STAGE(PG8_SB(0, 1), b2 + hstep, voffB);
            PG8_WAIT_V(6); PG8_BAR; PG8_MMA(1, 1, At, B1); PG8_BAR;
            PG8_LDB(B0, 1, 0); PG8_SCHED; PG8_LDA(At, 1, 0); PG8_STAGE(PG8_SA(0, 1), a2 + hstep, voffA);
            PG8_WAIT_L(8); PG8_BAR; PG8_WAIT_L(0); PG8_MMA(0, 0, At, B0); PG8_BAR; PG8_SCHED;
            PG8_LDB(B1, 1, 1); PG8_STAGE(PG8_SB(1, 0), b3, voffB);
            PG8_BAR; PG8_WAIT_L(0); PG8_MMA(0, 1, At, B1); PG8_BAR;
            PG8_LDA(At, 1, 1); PG8_STAGE(PG8_SA(1, 0), a3, voffA);
            PG8_BAR; PG8_WAIT_L(0); PG8_MMA(1, 0, At, B0); PG8_BAR; PG8_SCHED;
            PG8_STAGE(PG8_SB(1, 1), b3 + hstep, voffB);
            PG8_WAIT_V(6); PG8_BAR; PG8_MMA(1, 1, At, B1); PG8_BAR;
            }
        }
        if constexpr (ALIGN_EPI) { if (wr == 0) PG8_BAR; }
        if constexpr (!Epi::AFTER_DRAIN) { E(acc, cur, wr, wc, fr, fq); S.done(cur); }
        if (!has_next) break;
#pragma unroll
        for (int a = 0; a < 2; ++a)
#pragma unroll
            for (int b = 0; b < 2; ++b)
#pragma unroll
                for (int m = 0; m < 4; ++m)
#pragma unroll
                    for (int n = 0; n < 2; ++n) acc[a][b][m][n] = (f32x4){0.f, 0.f, 0.f, 0.f};
        cur = nxt; cA = nA; cB = nB; ++ui;
        if constexpr (ALIGN_EPI) { if (wr == 1) PG8_BAR; }
    }
    PG8_WAIT_V(0);
    if constexpr (!ALIGN_EPI) { if (wr == 0) PG8_BAR; }
    PG8_BAR;
    if constexpr (Epi::AFTER_DRAIN) { E.fused(acc, cur, wr, wc, fr, fq, lds, wid, lane); S.done(cur); }
#undef PG8_SA
#undef PG8_SB
#undef PG8_STAGE
#undef PG8_LDA
#undef PG8_LDB
#undef PG8_MMA
#undef PG8_WAIT_V
#undef PG8_WAIT_L
#undef PG8_BAR
#undef PG8_SCHED
}
}
namespace att {
#define ATT_LAS __attribute__((address_space(3)))
typedef unsigned short bf16_t;
typedef short bf16x8 __attribute__((ext_vector_type(8)));
typedef short s16x4 __attribute__((ext_vector_type(4)));
typedef float f32x16 __attribute__((ext_vector_type(16)));
typedef unsigned u32x4 __attribute__((ext_vector_type(4)));
typedef unsigned u32x2 __attribute__((ext_vector_type(2)));
constexpr int SEQ = 2048, ZP = 3328, YP = 1024;
constexpr int C_QA = 0, C_KA = 512, C_VA = 640, C_GA = 768, C_QB = 1280, C_KB = 1792, C_VB = 2304, C_GB = 2816;
constexpr int SLOT = 8192;
constexpr int TBL_OFF = 2 * 4 * 2 * SLOT;
constexpr int ATT_LDS_BYTES = TBL_OFF + 4096;
constexpr float LOG2E = 1.4426950408889634f;
constexpr float QSCALE = 0.125f * LOG2E;
constexpr float NEG_INIT = -1.0e30f;

__device__ __forceinline__ unsigned cvtpk(float lo, float hi) { unsigned r; asm volatile("v_cvt_pk_bf16_f32 %0, %1, %2" : "=v"(r) : "v"(lo), "v"(hi)); return r; }
__device__ __forceinline__ s16x4 vtr(const ATT_LAS unsigned char* p) { return __builtin_bit_cast(s16x4, __builtin_amdgcn_ds_read_tr16_b64_v4i16((ATT_LAS s16x4*)p)); }
__device__ __forceinline__ float swapmax(float m) { auto rr = __builtin_amdgcn_permlane32_swap(__float_as_uint(m), __float_as_uint(m), false, false); return fmaxf(__uint_as_float(rr[0]), __uint_as_float(rr[1])); }
__device__ __forceinline__ float swapsum(float m) { auto rr = __builtin_amdgcn_permlane32_swap(__float_as_uint(m), __float_as_uint(m), false, false); return __uint_as_float(rr[0]) + __uint_as_float(rr[1]); }

template <bool FAR>
__device__ __forceinline__ void tile_compute(const ATT_LAS unsigned char* Kb, const ATT_LAS unsigned char* Vb, const ATT_LAS float* tb, float cfar,
                                             const bf16x8 (&qf)[4], f32x16 (&o)[2], float& m_run, float& l_run, int r32, int hi, int lane) {
    f32x16 s0, s1;
    if (FAR) {
#pragma unroll
        for (int r = 0; r < 16; ++r) { s0[r] = cfar; s1[r] = cfar; }
    } else {
#pragma unroll
        for (int r = 0; r < 16; ++r) { s0[r] = tb[(r & 3) + 8 * (r >> 2)]; s1[r] = tb[32 + (r & 3) + 8 * (r >> 2)]; }
    }
    const int ksw = (r32 >> 1) & 7;
#pragma unroll
    for (int ds = 0; ds < 4; ++ds) {
        const int c8 = 2 * ds + hi;
        const ATT_LAS unsigned char* kp = Kb + r32 * 128 + ((c8 ^ ksw) << 4);
        const bf16x8 a0 = *(const ATT_LAS bf16x8*)kp, a1 = *(const ATT_LAS bf16x8*)(kp + 32 * 128);
        s0 = __builtin_amdgcn_mfma_f32_32x32x16_bf16(a0, qf[ds], s0, 0, 0, 0);
        s1 = __builtin_amdgcn_mfma_f32_32x32x16_bf16(a1, qf[ds], s1, 0, 0, 0);
    }
    float mt = fmaxf(s0[0], s1[0]);
#pragma unroll
    for (int r = 1; r < 16; ++r) mt = fmaxf(mt, fmaxf(s0[r], s1[r]));
    mt = swapmax(mt);
    const float mn = fmaxf(m_run, mt), alpha = __builtin_amdgcn_exp2f(m_run - mn);
    m_run = mn;
    float ls = 0.f;
#pragma unroll
    for (int r = 0; r < 16; ++r) { s0[r] = __builtin_amdgcn_exp2f(s0[r] - mn); s1[r] = __builtin_amdgcn_exp2f(s1[r] - mn); ls += s0[r] + s1[r]; }
    l_run = l_run * alpha + ls;
#pragma unroll
    for (int r = 0; r < 16; ++r) { o[0][r] *= alpha; o[1][r] *= alpha; }
    u32x4 pw[4];
    pw[0] = (u32x4){cvtpk(s0[0], s0[1]), cvtpk(s0[2], s0[3]), cvtpk(s0[4], s0[5]), cvtpk(s0[6], s0[7])};
    pw[1] = (u32x4){cvtpk(s0[8], s0[9]), cvtpk(s0[10], s0[11]), cvtpk(s0[12], s0[13]), cvtpk(s0[14], s0[15])};
    pw[2] = (u32x4){cvtpk(s1[0], s1[1]), cvtpk(s1[2], s1[3]), cvtpk(s1[4], s1[5]), cvtpk(s1[6], s1[7])};
    pw[3] = (u32x4){cvtpk(s1[8], s1[9]), cvtpk(s1[10], s1[11]), cvtpk(s1[12], s1[13]), cvtpk(s1[14], s1[15])};
    const int q4 = (lane >> 2) & 3, p4 = lane & 3, g1 = (lane >> 4) & 1;
#pragma unroll
    for (int db = 0; db < 2; ++db) {
        const ATT_LAS unsigned char* vp = Vb + (4 * hi + q4) * 128 + ((db ^ ((q4 >> 1) & 1)) << 6) + 32 * g1 + 8 * p4;
#pragma unroll
        for (int j = 0; j < 4; ++j) {
            const s16x4 lo = vtr(vp + 2048 * j), hh = vtr(vp + 2048 * j + 1024);
            const bf16x8 vf = (bf16x8){lo[0], lo[1], lo[2], lo[3], hh[0], hh[1], hh[2], hh[3]};
            o[db] = __builtin_amdgcn_mfma_f32_32x32x16_bf16(vf, __builtin_bit_cast(bf16x8, pw[j]), o[db], 0, 0, 0);
        }
    }
}

template <bool IS_A>
__device__ __forceinline__ void attn_unit(ATT_LAS unsigned char* lds, const bf16_t* __restrict__ Z, bf16_t* __restrict__ Y, const float* __restrict__ sink, const float* __restrict__ relb, int b, int c, int grp) {
    const int tid = threadIdx.x, lane = tid & 63, w = __builtin_amdgcn_readfirstlane(tid >> 6), r32 = lane & 31, hi = lane >> 5;
    const int hl = w & 3, qblk = w >> 2;
    constexpr int NPREV = IS_A ? 2 : 8;
    const int head = grp * 4 + hl;
    const int qcol = (IS_A ? C_QA : C_QB) + head * 64;
    const int kcol = IS_A ? (C_KA + grp * 64) : (C_KB + head * 64);
    const int vcol = IS_A ? (C_VA + grp * 64) : (C_VB + head * 64);
    const int gcol = (IS_A ? C_GA : C_GB) + head * 64;
    const int ycol = (IS_A ? 0 : 512) + head * 64;
    const size_t tok0 = (size_t)b * SEQ + (size_t)c * 64;
    ATT_LAS float* tbl = (ATT_LAS float*)(lds + TBL_OFF);
    for (int e = tid; e < 1024; e += 512) {
        const int h4 = e >> 8, i = e & 255, rel = 191 - i; float v;
        if (IS_A) { const float slope = __builtin_amdgcn_exp2f(-(float)(grp * 4 + h4 + 1)); v = -slope * fabsf((float)rel) * LOG2E; }
        else { int idx = rel; idx = idx < -128 ? -128 : idx; idx = idx > 128 ? 128 : idx; v = relb[(grp * 4 + h4) * 257 + idx + 128] * LOG2E; }
        tbl[e] = v;
    }
    float cfar = 0.f;
    if (!IS_A) cfar = relb[head * 257 + 256] * LOG2E;
    bf16x8 qf[4];
    { const bf16_t* qp = Z + (tok0 + qblk * 32 + r32) * ZP + qcol + hi * 8;
#pragma unroll
      for (int ds = 0; ds < 4; ++ds) qf[ds] = *(const bf16x8*)(qp + ds * 16); }
    f32x16 o[2];
#pragma unroll
    for (int r = 0; r < 16; ++r) { o[0][r] = 0.f; o[1][r] = 0.f; }
    float m_run, l_run;
    if (IS_A) { m_run = sink[head] * LOG2E; l_run = (hi == 0) ? 1.0f : 0.0f; } else { m_run = NEG_INIT; l_run = 0.f; }
    constexpr int NST = IS_A ? 1 : 4;
    const int srow = (IS_A ? w * 8 : qblk * 32) + (lane >> 3), sch = lane & 7;
    const int slot = IS_A ? 0 : hl;
    u32x4 kreg[NST], vreg[NST];
    const int j0 = (c >= NPREV) ? 0 : (NPREV - c);
    const bf16_t* zk = Z + sch * 8;
#define ATT_LOAD(j) do { _Pragma("unroll") for (int s = 0; s < NST; ++s) { const bf16_t* p_ = zk + (size_t)(b * SEQ + (c - NPREV + (j)) * 64 + srow + 8 * s) * ZP; \
        kreg[s] = *(const u32x4*)(p_ + kcol); vreg[s] = *(const u32x4*)(p_ + vcol); } } while (0)
    ATT_LOAD(j0);
    int buf = 0;
    for (int j = j0; j <= NPREV; ++j) {
        ATT_LAS unsigned char* Kb = lds + ((buf * 4 + slot) * 2) * SLOT; ATT_LAS unsigned char* Vb = Kb + SLOT;
#pragma unroll
        for (int s = 0; s < NST; ++s) { const int row = srow + 8 * s;
            *(ATT_LAS u32x4*)(Kb + row * 128 + ((sch ^ ((row >> 1) & 7)) << 4)) = kreg[s];
            *(ATT_LAS u32x4*)(Vb + row * 128 + (((sch >> 2) ^ ((row >> 1) & 1)) << 6) + ((sch & 3) << 4)) = vreg[s]; }
        __syncthreads();
        if (j < NPREV) ATT_LOAD(j + 1);
        const int D = (NPREV - j) * 64;
        if (!IS_A && D >= 192) tile_compute<true>(Kb, Vb, tbl, cfar, qf, o, m_run, l_run, r32, hi, lane);
        else tile_compute<false>(Kb, Vb, tbl + hl * 256 + (191 - (qblk * 32 + r32) - D + 4 * hi), cfar, qf, o, m_run, l_run, r32, hi, lane);
        buf ^= 1;
    }
#undef ATT_LOAD
    const float linv = 1.0f / swapsum(l_run);
    { const size_t tq = tok0 + qblk * 32 + r32; const bf16_t* gp = Z + tq * ZP + gcol + 4 * hi; bf16_t* yp = Y + tq * YP + ycol + 4 * hi;
#pragma unroll
      for (int db = 0; db < 2; ++db)
#pragma unroll
        for (int t = 0; t < 4; ++t) { const u32x2 gw = *(const u32x2*)(gp + 32 * db + 8 * t);
            const float g0 = __uint_as_float(gw.x << 16), g1v = __uint_as_float(gw.x & 0xffff0000u), g2 = __uint_as_float(gw.y << 16), g3 = __uint_as_float(gw.y & 0xffff0000u);
            const float y0 = o[db][4 * t + 0] * linv * g0 * __builtin_amdgcn_rcpf(1.0f + __builtin_amdgcn_exp2f(-LOG2E * g0));
            const float y1 = o[db][4 * t + 1] * linv * g1v * __builtin_amdgcn_rcpf(1.0f + __builtin_amdgcn_exp2f(-LOG2E * g1v));
            const float y2 = o[db][4 * t + 2] * linv * g2 * __builtin_amdgcn_rcpf(1.0f + __builtin_amdgcn_exp2f(-LOG2E * g2));
            const float y3 = o[db][4 * t + 3] * linv * g3 * __builtin_amdgcn_rcpf(1.0f + __builtin_amdgcn_exp2f(-LOG2E * g3));
            u32x2 yw; yw.x = cvtpk(y0, y1); yw.y = cvtpk(y2, y3); *(u32x2*)(yp + 32 * db + 8 * t) = yw; } }
    __syncthreads();
}

__device__ __forceinline__ void attn_phase(ATT_LAS unsigned char* lds, const bf16_t* Z, bf16_t* Y, const float* sink, const float* relb, int vcu, int G) {
    for (int u = vcu; u < 2048; u += G) { const int pair = u >> 5, c = ((u & 31) + 4 * (u >> 8)) & 31; attn_unit<false>(lds, Z, Y, sink, relb, pair >> 1, c, pair & 1); }
    for (int u = vcu; u < 2048; u += G) { const int pair = u >> 5, c = ((u & 31) + 4 * (u >> 8)) & 31; attn_unit<true>(lds, Z, Y, sink, relb, pair >> 1, c, pair & 1); }
}
}
#define LAS __attribute__((address_space(3)))
typedef unsigned short bf16;
typedef unsigned v4u __attribute__((ext_vector_type(4)));
typedef float f32x4 __attribute__((ext_vector_type(4)));
constexpr int NWAVES = 8;
constexpr int M = 65536, D = 1024, NIN = 3328, PLE = 256;
constexpr float RMS_EPS = 1e-6f;
constexpr size_t MiB = 1u << 20;
constexpr size_t WS_WIN = 0, WS_WOUT = 7 * MiB, WS_WG = 9 * MiB, WS_WP = 11 * MiB, WS_PART = 12 * MiB;
constexpr size_t WS_XN = 16 * MiB;
constexpr size_t WS_Z = WS_XN + 128 * MiB;
constexpr size_t WS_HB = WS_Z + 416 * MiB;
constexpr size_t WS_PP = WS_HB + 128 * MiB;
constexpr size_t WS_PB = WS_PP + 128 * MiB;
constexpr size_t WS_END = WS_PB + 32 * MiB;
constexpr int LDS_BYTES = 139264;

__device__ __forceinline__ unsigned f2bf(float f) { unsigned u = __builtin_bit_cast(unsigned, f); return (u + 0x7fffu + ((u >> 16) & 1u)) >> 16; }
__device__ __forceinline__ unsigned pk2(float lo, float hi) { return f2bf(lo) | (f2bf(hi) << 16); }
__device__ __forceinline__ float wave_sum(float v) {
#pragma unroll
    for (int o = 1; o < 64; o <<= 1) v += __shfl_xor(v, o);
    return v;
}
__device__ __forceinline__ void transpose_item(const float* W, int K, int N, bf16* WT, const float* gk, LAS float* scr, int item, int lane) {
    const int nblk = N / 32, kb = item / nblk, nb = item % nblk, k0 = 64 * kb, n0 = 32 * nb;
#pragma unroll 8
    for (int i = 0; i < 32; ++i) { const int kk = 2 * i + (lane >> 5); const float g = gk ? gk[k0 + kk] : 1.0f; scr[kk * 33 + (lane & 31)] = W[(size_t)(k0 + kk) * N + n0 + (lane & 31)] * g; }
    asm volatile("s_waitcnt lgkmcnt(0)" ::: "memory");
    const int c = lane & 7;
#pragma unroll
    for (int j = 0; j < 4; ++j) { const int n = (lane >> 3) + 8 * j; const LAS float* s = scr + (8 * c) * 33 + n;
        v4u o; o.x = pk2(s[0 * 33], s[1 * 33]); o.y = pk2(s[2 * 33], s[3 * 33]); o.z = pk2(s[4 * 33], s[5 * 33]); o.w = pk2(s[6 * 33], s[7 * 33]);
        *(v4u*)(WT + (size_t)(n0 + n) * K + k0 + 8 * c) = o; }
    asm volatile("s_waitcnt lgkmcnt(0)" ::: "memory");
}
__device__ __forceinline__ void rms_row_to_bf16(const float* xrow, const float* g, bf16* orow, int lane) {
    const f32x4* xr = (const f32x4*)xrow + lane; const f32x4* gr = (const f32x4*)g + lane;
    f32x4 v[4]; float s = 0.f;
#pragma unroll
    for (int j = 0; j < 4; ++j) { v[j] = xr[64 * j]; s += (v[j].x * v[j].x + v[j].y * v[j].y) + (v[j].z * v[j].z + v[j].w * v[j].w); }
    const float rstd = 1.0f / sqrtf(wave_sum(s) * (1.0f / D) + RMS_EPS);
    unsigned long long* o8 = (unsigned long long*)orow + lane;
#pragma unroll
    for (int j = 0; j < 4; ++j) { const f32x4 gg = gr[64 * j]; o8[64 * j] = (unsigned long long)pk2(v[j].x * rstd * gg.x, v[j].y * rstd * gg.y) | ((unsigned long long)pk2(v[j].z * rstd * gg.z, v[j].w * rstd * gg.w) << 32); }
}
__device__ __forceinline__ void rms_row_inplace(float* row, const float* g, int lane) {
    f32x4* xr = (f32x4*)row + lane; const f32x4* gr = (const f32x4*)g + lane;
    f32x4 v[4]; float s = 0.f;
#pragma unroll
    for (int j = 0; j < 4; ++j) { v[j] = xr[64 * j]; s += (v[j].x * v[j].x + v[j].y * v[j].y) + (v[j].z * v[j].z + v[j].w * v[j].w); }
    const float rstd = 1.0f / sqrtf(wave_sum(s) * (1.0f / D) + RMS_EPS);
#pragma unroll
    for (int j = 0; j < 4; ++j) { const f32x4 gg = gr[64 * j]; xr[64 * j] = (f32x4){v[j].x * rstd * gg.x, v[j].y * rstd * gg.y, v[j].z * rstd * gg.z, v[j].w * rstd * gg.w}; }
}

struct Args { const float* x; const float* p; const float* norm_g; const float* w_in; const float* sink_a; const float* rel_bias_b; const float* w_out; const float* ple_norm_g;
              const float* w_ple_proj; const float* w_ple_gate; const float* final_norm_g; float* out; unsigned char* ws; };

__global__ void __launch_bounds__(NWAVES * 64) fwd_megakernel(Args a) {
    extern __shared__ __attribute__((aligned(16))) unsigned char lds_raw[];
    LAS unsigned char* lds = (LAS unsigned char*)lds_raw;
    cg::grid_group grid = cg::this_grid();
    const int tid = threadIdx.x, lane = tid & 63, wave = __builtin_amdgcn_readfirstlane(tid >> 6);
    const int G = gridDim.x, bx = blockIdx.x;
    const int vcu = (G % 8 == 0) ? (bx % 8) * (G / 8) + bx / 8 : bx;
    unsigned char* ws = a.ws;
    bf16* Win_t = (bf16*)(ws + WS_WIN); bf16* Wout_t = (bf16*)(ws + WS_WOUT); bf16* Wg_t = (bf16*)(ws + WS_WG); bf16* Wp_t = (bf16*)(ws + WS_WP);
    float* part = (float*)(ws + WS_PART);
    bf16* XN = (bf16*)(ws + WS_XN); bf16* Y = XN; bf16* Z = (bf16*)(ws + WS_Z); bf16* HB = (bf16*)(ws + WS_HB); bf16* PP = (bf16*)(ws + WS_PP); bf16* PB = (bf16*)(ws + WS_PB);

    {
        LAS float* scr = (LAS float*)(lds + wave * 16384);
        const int gw = vcu * NWAVES + wave, NGW = G * NWAVES;
        constexpr int I_IN = (D / 64) * (NIN / 32), I_OUT = (D / 64) * (D / 32), I_G = I_OUT, I_P = (PLE / 64) * (D / 32);
        for (int it = gw; it < I_IN + I_OUT + I_G + I_P; it += NGW) {
            int r = it;
            if (r < I_IN) { transpose_item(a.w_in, D, NIN, Win_t, nullptr, scr, r, lane); continue; } r -= I_IN;
            if (r < I_OUT) { transpose_item(a.w_out, D, D, Wout_t, nullptr, scr, r, lane); continue; } r -= I_OUT;
            if (r < I_G) { transpose_item(a.w_ple_gate, D, D, Wg_t, a.ple_norm_g, scr, r, lane); continue; } r -= I_G;
            transpose_item(a.w_ple_proj, PLE, D, Wp_t, nullptr, scr, r, lane);
        }
        for (int m = gw; m < M; m += NGW) rms_row_to_bf16(a.x + (size_t)m * D, a.norm_g, XN + (size_t)m * D, lane);
        const size_t n8 = (size_t)M * PLE / 8, gt = (size_t)vcu * (NWAVES * 64) + tid, ngt = (size_t)G * NWAVES * 64;
        for (size_t i = gt; i < n8; i += ngt) { const f32x4 p0 = *((const f32x4*)a.p + 2 * i), p1 = *((const f32x4*)a.p + 2 * i + 1);
            v4u o; o.x = pk2(p0.x, p0.y); o.y = pk2(p0.z, p0.w); o.z = pk2(p1.x, p1.y); o.w = pk2(p1.z, p1.w); *((v4u*)PB + i) = o; }
    }
    grid.sync();
    { pg8::Gemm g{XN, Win_t, M, NIN, D}; pg8::StaticOrder S; S.init(M, NIN, G, bx);
      pg8::EpiBf16S E{Z, NIN, att::QSCALE, (1u << 0) | (1u << 1) | (1u << 5) | (1u << 6)};
      pg8::gemm_phase<pg8::EpiBf16S, pg8::StaticOrder, true, true>(lds, g, S, E); }
    grid.sync();
    att::attn_phase(lds, Z, Y, a.sink_a, a.rel_bias_b, vcu, G);
    grid.sync();
    { pg8::Gemm g{Y, Wout_t, M, D, D}; pg8::StaticOrder S; S.init(M, D, G, bx);
      pg8::EpiRes E{a.x, a.out, HB, part};
      pg8::gemm_phase<pg8::EpiRes, pg8::StaticOrder, true, true>(lds, g, S, E); }
    { pg8::Gemm g{PB, Wp_t, M, D, PLE}; pg8::StaticOrder S; S.init(M, D, G, bx);
      pg8::EpiBf16S E{PP, D, 1.0f, 0u};
      pg8::gemm_phase<pg8::EpiBf16S, pg8::StaticOrder, true, true>(lds, g, S, E); }
    grid.sync();
    { pg8::Gemm g{HB, Wg_t, M, D, D}; pg8::StaticOrder S; S.init(M, D, G, bx);
      pg8::EpiFin E{a.out, PP, part, RMS_EPS};
      pg8::gemm_phase<pg8::EpiFin, pg8::StaticOrder, true, true>(lds, g, S, E); }
    grid.sync();
    { const int gw = vcu * NWAVES + wave, NGW = G * NWAVES;
      for (int m = gw; m < M; m += NGW) rms_row_inplace(a.out + (size_t)m * D, a.final_norm_g, lane); }
}

extern "C" void kernel_launch(void* const* d_in, const int* in_sizes, int n_in, void* d_out, int out_size, void* d_ws, size_t ws_size, hipStream_t stream) {
    static int grid_blocks = 0;
    if (grid_blocks == 0) {
        if (n_in != 11 || in_sizes[0] != M * D || out_size != M * D || ws_size < WS_END) { fprintf(stderr, "kernel_launch: unexpected shapes (n_in %d, in0 %d, out %d, ws %zu < %zu)\n", n_in, n_in > 0 ? in_sizes[0] : -1, out_size, ws_size, (size_t)WS_END); grid_blocks = -1; return; }
        int dev = 0, cus = 0, per_cu = 0;
        hipGetDevice(&dev);
        hipDeviceGetAttribute(&cus, hipDeviceAttributeMultiprocessorCount, dev);
        if (hipFuncSetAttribute((const void*)fwd_megakernel, hipFuncAttributeMaxDynamicSharedMemorySize, LDS_BYTES) != hipSuccess) { fprintf(stderr, "kernel_launch: hipFuncSetAttribute failed\n"); grid_blocks = -1; return; }
        if (hipOccupancyMaxActiveBlocksPerMultiprocessor(&per_cu, (const void*)fwd_megakernel, NWAVES * 64, LDS_BYTES) != hipSuccess || per_cu < 1) { fprintf(stderr, "kernel_launch: occupancy query says %d\n", per_cu); per_cu = 1; (void)hipGetLastError(); }
        grid_blocks = cus * per_cu;
    }
    if (grid_blocks < 0) return;
    Args a{};
    a.x = (const float*)d_in[0]; a.p = (const float*)d_in[1]; a.norm_g = (const float*)d_in[2]; a.w_in = (const float*)d_in[3]; a.sink_a = (const float*)d_in[4];
    a.rel_bias_b = (const float*)d_in[5]; a.w_out = (const float*)d_in[6]; a.ple_norm_g = (const float*)d_in[7]; a.w_ple_proj = (const float*)d_in[8]; a.w_ple_gate = (const float*)d_in[9];
    a.final_norm_g = (const float*)d_in[10]; a.out = (float*)d_out; a.ws = (unsigned char*)d_ws;
    void* args[] = {&a};
    hipError_t e = hipLaunchCooperativeKernel((const void*)fwd_megakernel, dim3(grid_blocks), dim3(NWAVES * 64), args, LDS_BYTES, stream);
    if (e != hipSuccess) fprintf(stderr, "cooperative launch failed: %s (grid %d)\n", hipGetErrorString(e), grid_blocks);
}
```
